# Optimizing an MI355X kernel written in HIP

```python
import math
import jax, jax.numpy as jnp
from jax import lax
import numpy as np

D_MODEL = 1024
BATCH = 8
SEQ = 2048
DEPTH = 1

N_HEADS = 8
HEAD_DIM = 64
V_DIM = 2 * HEAD_DIM
QK_WIDTH = N_HEADS * 2 * HEAD_DIM
ATTN_WIDTH = N_HEADS * V_DIM
Q_BLOCK = 128
SSM_WIDTH = D_MODEL // 2
SSM_GROUP = 16
SSM_GROUPS = SSM_WIDTH // SSM_GROUP
SSM_STATE = 64
DT_MIN = 1e-3
DT_MAX = 1e-1
D_FF = 4 * D_MODEL
N_BUCKETS = 32
MAX_DISTANCE = 128
EPS = 1e-6
IN_WIDTH = 2 * QK_WIDTH + ATTN_WIDTH + SSM_WIDTH + 2 * D_MODEL
SPLITS = [QK_WIDTH, 2 * QK_WIDTH, 2 * QK_WIDTH + ATTN_WIDTH,
          2 * QK_WIDTH + ATTN_WIDTH + SSM_WIDTH,
          2 * QK_WIDTH + ATTN_WIDTH + SSM_WIDTH + D_MODEL]

kernel_name = 'hybrid_diffattn_s5_gated_block'


def rmsnorm(x, g):
    xf = x.astype(jnp.float32)
    y = xf * lax.rsqrt(jnp.mean(xf * xf, axis=-1, keepdims=True) + EPS)
    return (y * g.astype(jnp.float32)).astype(x.dtype)


def lambda_init_fn(layer):
    return 0.8 - 0.6 * math.exp(-0.3 * layer)


def t5_bucket(rel):
    n = jnp.maximum(rel, 0)
    max_exact = N_BUCKETS // 2
    is_small = n < max_exact
    large = max_exact + (jnp.log(jnp.maximum(n, 1).astype(jnp.float32) / max_exact)
                         / math.log(MAX_DISTANCE / max_exact)
                         * (N_BUCKETS - max_exact)).astype(jnp.int32)
    large = jnp.minimum(large, N_BUCKETS - 1)
    return jnp.where(is_small, n, large)


def diff_attention(q, k, v, rel_bias, lam, subln_g, lam_init):
    b, l = q.shape[0], q.shape[1]
    nb = l // Q_BLOCK
    q = q.reshape(b, l, N_HEADS, 2, HEAD_DIM).transpose(0, 2, 3, 1, 4)
    k = k.reshape(b, l, N_HEADS, 2, HEAD_DIM).transpose(0, 2, 3, 1, 4)
    v = v.reshape(b, l, N_HEADS, V_DIM).transpose(0, 2, 1, 3)
    q_blocks = q.reshape(b, N_HEADS, 2, nb, Q_BLOCK, HEAD_DIM).transpose(3, 0, 1, 2, 4, 5)
    k_pos = jnp.arange(l)
    scale = HEAD_DIM ** -0.5

    def one_block(args):
        q_blk, i = args
        q_pos = i * Q_BLOCK + jnp.arange(Q_BLOCK)
        rel = q_pos[:, None] - k_pos[None, :]
        bias = rel_bias[t5_bucket(rel)].astype(jnp.float32).transpose(2, 0, 1)
        s = jnp.einsum('bhmqd,bhmkd->bhmqk', q_blk, k).astype(jnp.float32) * scale
        s = s + bias[None, :, None]
        s = jnp.where((rel >= 0)[None, None, None], s, -jnp.inf)
        p = jax.nn.softmax(s, axis=-1)
        w = p[:, :, 0] - lam * p[:, :, 1]
        return jnp.einsum('bhqk,bhkv->bhqv', w.astype(v.dtype), v)

    o = lax.map(one_block, (q_blocks, jnp.arange(nb)))
    o = o.transpose(1, 0, 3, 2, 4).reshape(b, l, N_HEADS, V_DIM)
    o = rmsnorm(o, subln_g) * (1.0 - lam_init)
    return o.reshape(b, l, ATTN_WIDTH)


def _complex_affine_combine(e1, e2):
    a1r, a1i, b1r, b1i = e1
    a2r, a2i, b2r, b2i = e2
    ar = a2r * a1r - a2i * a1i
    ai = a2r * a1i + a2i * a1r
    br = a2r * b1r - a2i * b1i + b2r
    bi = a2r * b1i + a2i * b1r + b2i
    return (ar, ai, br, bi)


def s5_ssm(u, a_re, a_im, log_dt, b_re, b_im, c_re, c_im, d_skip):
    bsz, l = u.shape[0], u.shape[1]
    uf = u.astype(jnp.float32).reshape(bsz, l, SSM_GROUPS, SSM_GROUP)
    dt = jnp.exp(log_dt.astype(jnp.float32))[:, None]
    ar = a_re.astype(jnp.float32)
    ai = a_im.astype(jnp.float32)
    mag = jnp.exp(ar * dt)
    lb_re = mag * jnp.cos(ai * dt)
    lb_im = mag * jnp.sin(ai * dt)
    nr = lb_re - 1.0
    ni = lb_im
    den = ar * ar + ai * ai
    cr = ((nr * ar + ni * ai) / den)[..., None]
    ci = ((ni * ar - nr * ai) / den)[..., None]
    br = b_re.astype(jnp.float32)
    bi = b_im.astype(jnp.float32)
    bb_re = cr * br - ci * bi
    bb_im = cr * bi + ci * br
    bu_re = jnp.einsum('blgh,gph->blgp', uf, bb_re)
    bu_im = jnp.einsum('blgh,gph->blgp', uf, bb_im)
    lam_re = jnp.broadcast_to(lb_re, bu_re.shape)
    lam_im = jnp.broadcast_to(lb_im, bu_im.shape)
    _, _, s_re, s_im = lax.associative_scan(
        _complex_affine_combine, (lam_re, lam_im, bu_re, bu_im), axis=1)
    y = (jnp.einsum('blgp,ghp->blgh', s_re, c_re.astype(jnp.float32))
         - jnp.einsum('blgp,ghp->blgh', s_im, c_im.astype(jnp.float32))
         + d_skip.astype(jnp.float32).reshape(SSM_GROUPS, SSM_GROUP) * uf)
    return y.reshape(bsz, l, SSM_WIDTH).astype(u.dtype)


def setup_inputs(seed: int = 0) -> dict:
    key = jax.random.key(seed)
    ks = jax.random.split(key, 24)
    f32 = jnp.float32
    nrm = lambda k, shape, s: jax.random.normal(k, shape, f32) * s
    n_idx = jnp.arange(SSM_STATE, dtype=f32)
    a_re = -0.5 + nrm(ks[9], (DEPTH, SSM_GROUPS, SSM_STATE), 0.01)
    a_im = math.pi * n_idx[None, None, :] + nrm(ks[10], (DEPTH, SSM_GROUPS, SSM_STATE), 0.01)
    log_dt = jax.random.uniform(ks[11], (DEPTH, SSM_GROUPS), f32,
                                math.log(DT_MIN), math.log(DT_MAX))
    b_scale = (0.5 / SSM_GROUP) ** 0.5
    c_scale = (0.5 / SSM_STATE) ** 0.5
    return {
        'x': jax.random.normal(ks[0], (BATCH, SEQ, D_MODEL), f32),
        'g_mix': 1.0 + nrm(ks[1], (DEPTH, D_MODEL), 0.02),
        'w_in': nrm(ks[2], (DEPTH, D_MODEL, IN_WIDTH), D_MODEL ** -0.5),
        'lambda_q1': nrm(ks[3], (DEPTH, HEAD_DIM), 0.1),
        'lambda_k1': nrm(ks[4], (DEPTH, HEAD_DIM), 0.1),
        'lambda_q2': nrm(ks[5], (DEPTH, HEAD_DIM), 0.1),
        'lambda_k2': nrm(ks[6], (DEPTH, HEAD_DIM), 0.1),
        'subln_g': 1.0 + nrm(ks[7], (DEPTH, V_DIM), 0.02),
        'rel_bias': nrm(ks[8], (N_BUCKETS, N_HEADS), 0.5),
        'ssm_a_re': a_re,
        'ssm_a_im': a_im,
        'ssm_log_dt': log_dt,
        'ssm_b_re': nrm(ks[12], (DEPTH, SSM_GROUPS, SSM_STATE, SSM_GROUP), b_scale),
        'ssm_b_im': nrm(ks[13], (DEPTH, SSM_GROUPS, SSM_STATE, SSM_GROUP), b_scale),
        'ssm_c_re': nrm(ks[14], (DEPTH, SSM_GROUPS, SSM_GROUP, SSM_STATE), c_scale),
        'ssm_c_im': nrm(ks[15], (DEPTH, SSM_GROUPS, SSM_GROUP, SSM_STATE), c_scale),
        'ssm_d': nrm(ks[16], (DEPTH, SSM_WIDTH), 1.0),
        'w_glu': nrm(ks[17], (DEPTH, SSM_WIDTH, 2 * D_MODEL), SSM_WIDTH ** -0.5),
        'w_out': nrm(ks[18], (DEPTH, D_MODEL, D_MODEL), D_MODEL ** -0.5),
        'g_mlp': 1.0 + nrm(ks[19], (DEPTH, D_MODEL), 0.02),
        'w1': nrm(ks[20], (DEPTH, D_MODEL, D_FF), D_MODEL ** -0.5),
        'w2': nrm(ks[21], (DEPTH, D_FF, D_MODEL), D_FF ** -0.5),
        'g_final': 1.0 + nrm(ks[22], (D_MODEL,), 0.02),
    }


def reference(x, g_mix, w_in, lambda_q1, lambda_k1, lambda_q2, lambda_k2, subln_g,
              rel_bias, ssm_a_re, ssm_a_im, ssm_log_dt, ssm_b_re, ssm_b_im,
              ssm_c_re, ssm_c_im, ssm_d, w_glu, w_out, g_mlp, w1, w2, g_final):
    for layer in range(DEPTH):
        h = rmsnorm(x, g_mix[layer])
        proj = h @ w_in[layer]
        q, k, v, u, gate_a, gate_s = jnp.split(proj, SPLITS, axis=-1)
        lam_init = lambda_init_fn(layer)
        lam = (jnp.exp(jnp.sum(lambda_q1[layer].astype(jnp.float32) * lambda_k1[layer].astype(jnp.float32)))
               - jnp.exp(jnp.sum(lambda_q2[layer].astype(jnp.float32) * lambda_k2[layer].astype(jnp.float32)))
               + lam_init)
        attn = diff_attention(q, k, v, rel_bias, lam, subln_g[layer], lam_init)
        y = s5_ssm(u, ssm_a_re[layer], ssm_a_im[layer], ssm_log_dt[layer],
                   ssm_b_re[layer], ssm_b_im[layer], ssm_c_re[layer], ssm_c_im[layer],
                   ssm_d[layer])
        z = jax.nn.gelu(y) @ w_glu[layer]
        z_val, z_gate = jnp.split(z, 2, axis=-1)
        ssm = z_val * jax.nn.sigmoid(z_gate)
        mixed = jax.nn.sigmoid(gate_a) * attn + jax.nn.sigmoid(gate_s) * ssm
        x = x + mixed @ w_out[layer]
        h = rmsnorm(x, g_mlp[layer])
        x = x + jnp.square(jax.nn.relu(h @ w1[layer])) @ w2[layer]
    return rmsnorm(x, g_final)
```

```cpp
#include <hip/hip_runtime.h>
#include <cstdio>
#include <cstdint>
#include <cmath>

constexpr int BATCH = 8, SEQ = 2048, DM = 1024, MTOK = BATCH * SEQ;
constexpr int NH = 8, HD = 64, VD = 128;
constexpr int INW = 5632, SSMW = 512, NG = 32, GH = 16, NP = 64, DFF = 4096;
constexpr int CT = 16, NCH = SEQ / CT, UA_LD = 384;
constexpr float EPS = 1e-6f;
constexpr float LOG2E = 1.4426950408889634f;
constexpr float C2 = 0.125f * LOG2E;
constexpr float LAM_INIT = 0.2f;
constexpr int BT_LEN = 640, BT_ZERO = 255;

constexpr size_t MiB = 1u << 20;
constexpr size_t WS_CTL = 0, WS_MISC = 1 * MiB;
constexpr size_t MISC_LAM = 0, MISC_BT = 1024, MISC_LAM16 = 32768;
constexpr size_t WS_WIN = 2 * MiB, WS_WGLU = 13 * MiB, WS_WOUT = 15 * MiB, WS_W1 = 17 * MiB, WS_W2 = 25 * MiB;
constexpr size_t WS_MINT = 33 * MiB, WS_TB = 37 * MiB, WS_XCH = 44 * MiB;
constexpr size_t WS_XN = 48 * MiB, WS_Q = 80 * MiB, WS_K = 112 * MiB, WS_V = 144 * MiB, WS_GA = 176 * MiB, WS_UA = 208 * MiB, WS_S = 232 * MiB;
constexpr size_t WS_O0 = WS_XN, WS_GY = WS_Q, WS_HB = WS_Q, WS_END = 256 * MiB;
constexpr size_t OUT_GS = 0, OUT_O1 = 32 * MiB;

typedef unsigned short bf16;
typedef short bf16x8 __attribute__((ext_vector_type(8)));
typedef float f32x4 __attribute__((ext_vector_type(4)));
typedef unsigned u32x4 __attribute__((ext_vector_type(4)));
#define LAS __attribute__((address_space(3)))

__device__ __forceinline__ unsigned f2bf(float f) { unsigned u = __builtin_bit_cast(unsigned, f); return (u + 0x7fffu + ((u >> 16) & 1u)) >> 16; }
__device__ __forceinline__ unsigned pk2(float lo, float hi) { return f2bf(lo) | (f2bf(hi) << 16); }
__device__ __forceinline__ float bf2f(unsigned short h) { return __builtin_bit_cast(float, (unsigned)h << 16); }
__device__ __forceinline__ float bflo(unsigned w) { return __builtin_bit_cast(float, w << 16); }
__device__ __forceinline__ float bfhi(unsigned w) { return __builtin_bit_cast(float, w & 0xffff0000u); }
__device__ __forceinline__ float sigmoidf_(float v) { return 1.f / (1.f + __expf(-v)); }
__device__ __forceinline__ float gelu_tanh(float v) { const float u = 0.7978845608028654f * (v + 0.044715f * v * v * v); return 0.5f * v * (1.f + tanhf(u)); }
__device__ __forceinline__ float wave_sum(float v) {
#pragma unroll
    for (int o = 1; o < 64; o <<= 1) v += __shfl_xor(v, o);
    return v;
}

struct Bufs {
    const float* in[23]; float* out; unsigned char* ws;
};

__device__ __forceinline__ int glu_rowmap(int n) { const int bj = n >> 10, rem = n & 1023; return 256 * (rem >> 7) + 128 * bj + (rem & 127); }
__device__ __forceinline__ void p0_transpose_item(const float* W, int K, int N, bf16* WT, const float* gk, bool glu, LAS float* scr, int item, int lane) {
    const int nblk = N / 32, kb = item / nblk, nb = item % nblk, k0 = 64 * kb, n0 = 32 * nb;
#pragma unroll 8
    for (int i = 0; i < 32; ++i) { const int kk = 2 * i + (lane >> 5); float v = W[(size_t)(k0 + kk) * N + n0 + (lane & 31)]; if (gk) v *= gk[k0 + kk]; scr[kk * 33 + (lane & 31)] = v; }
    asm volatile("s_waitcnt lgkmcnt(0)" ::: "memory");
    const int c = lane & 7;
    const int nd0 = glu ? glu_rowmap(n0) : n0;
#pragma unroll
    for (int j = 0; j < 4; ++j) { const int n = (lane >> 3) + 8 * j; const LAS float* s = scr + (8 * c) * 33 + n;
        u32x4 o; o.x = pk2(s[0 * 33], s[1 * 33]); o.y = pk2(s[2 * 33], s[3 * 33]); o.z = pk2(s[4 * 33], s[5 * 33]); o.w = pk2(s[6 * 33], s[7 * 33]);
        *(u32x4*)(WT + (size_t)(nd0 + n) * K + k0 + 8 * c) = o; }
    asm volatile("s_waitcnt lgkmcnt(0)" ::: "memory");
}
constexpr int IT_IN = (DM / 64) * (INW / 32), IT_GLU = (SSMW / 64) * (2 * DM / 32), IT_OUT = (DM / 64) * (DM / 32), IT_W1 = (DM / 64) * (DFF / 32), IT_W2 = (DFF / 64) * (DM / 32);
constexpr int IT_ALL = IT_IN + IT_GLU + IT_OUT + IT_W1 + IT_W2;
__device__ __forceinline__ void p0_weights(const Bufs& B, LAS float* scr, int gw, int ngw, int lane) {
    unsigned char* ws = B.ws;
    for (int it = gw; it < IT_ALL; it += ngw) {
        int r = it;
        if (r < IT_IN) { p0_transpose_item(B.in[2], DM, INW, (bf16*)(ws + WS_WIN), B.in[1], false, scr, r, lane); continue; } r -= IT_IN;
        if (r < IT_GLU) { p0_transpose_item(B.in[17], SSMW, 2 * DM, (bf16*)(ws + WS_WGLU), nullptr, true, scr, r, lane); continue; } r -= IT_GLU;
        if (r < IT_OUT) { p0_transpose_item(B.in[18], DM, DM, (bf16*)(ws + WS_WOUT), nullptr, false, scr, r, lane); continue; } r -= IT_OUT;
        if (r < IT_W1) { p0_transpose_item(B.in[20], DM, DFF, (bf16*)(ws + WS_W1), B.in[19], false, scr, r, lane); continue; } r -= IT_W1;
        p0_transpose_item(B.in[21], DFF, DM, (bf16*)(ws + WS_W2), nullptr, false, scr, r, lane);
    }
}
__device__ __forceinline__ void rms_row_to_bf16(const float* xrow, bf16* orow, int lane) {
    const f32x4* xr = (const f32x4*)xrow + lane;
    f32x4 v[4]; float s = 0.f;
#pragma unroll
    for (int j = 0; j < 4; ++j) { v[j] = xr[64 * j]; s += (v[j].x * v[j].x + v[j].y * v[j].y) + (v[j].z * v[j].z + v[j].w * v[j].w); }
    const float rstd = 1.f / sqrtf(wave_sum(s) * (1.f / DM) + EPS);
    unsigned long long* o8 = (unsigned long long*)orow + lane;
#pragma unroll
    for (int j = 0; j < 4; ++j) o8[64 * j] = (unsigned long long)pk2(v[j].x * rstd, v[j].y * rstd) | ((unsigned long long)pk2(v[j].z * rstd, v[j].w * rstd) << 32);
}
__device__ __forceinline__ int t5_bucket_dev(int n) {
    if (n < 16) return n;
    int large = 16 + (int)(logf((float)n / 16.f) / logf(8.f) * 16.f);
    return large < 31 ? large : 31;
}
__device__ __forceinline__ void p0_misc(const Bufs& B, int t, int nt) {
    float* misc = (float*)(B.ws + WS_MISC);
    if (t == 0) {
        float s1 = 0.f, s2 = 0.f;
        for (int i = 0; i < HD; ++i) { s1 += B.in[3][i] * B.in[4][i]; s2 += B.in[5][i] * B.in[6][i]; }
        misc[MISC_LAM / 4] = expf(s1) - expf(s2) + LAM_INIT;
    }
    const float* rb = B.in[8];
    for (int i = t; i < NH * BT_LEN; i += nt) {
        const int h = i / BT_LEN, rel = (i % BT_LEN) - BT_ZERO;
        float v;
        if (rel < 0) v = -INFINITY;
        else { const int bk = t5_bucket_dev(rel < 128 ? rel : 128); v = (rb[bk * NH + h] - rb[31 * NH + h]) * LOG2E; }
        misc[MISC_BT / 4 + i] = v;
    }
}
__device__ __forceinline__ void p0_ssm_tables(const Bufs& B, int g, int tid, int nthr, LAS float* lds) {
    LAS float* LPr = lds;
    LAS float* LPi = lds + 17 * 64;
    LAS float* BBr = lds + 2 * 17 * 64;
    LAS float* BBi = BBr + 1024;
    LAS float* KD = BBi + 1024;
    const float* a_re = B.in[9]; const float* a_im = B.in[10]; const float* log_dt = B.in[11];
    const float* b_re = B.in[12]; const float* b_im = B.in[13]; const float* c_re = B.in[14]; const float* c_im = B.in[15]; const float* dsk = B.in[16];
    for (int p = tid; p < NP; p += nthr) {
        const double dt = exp((double)log_dt[g]); const double ar = a_re[g * NP + p], ai = a_im[g * NP + p];
        double l1r = 0, l1i = 0;
        for (int d = 0; d <= CT; ++d) { const double mag = exp(ar * dt * d), ang = ai * dt * d; const double lr = mag * cos(ang), li = mag * sin(ang);
            LPr[d * 64 + p] = (float)lr; LPi[d * 64 + p] = (float)li; if (d == 1) { l1r = lr; l1i = li; }
            if (d == CT) { float* l16 = (float*)(B.ws + WS_MISC + MISC_LAM16); l16[(g * NP + p) * 2] = (float)lr; l16[(g * NP + p) * 2 + 1] = (float)li; } }
        const double nr = l1r - 1.0, ni = l1i, den = ar * ar + ai * ai; const double cr = (nr * ar + ni * ai) / den, ci = (ni * ar - nr * ai) / den;
        for (int h = 0; h < GH; ++h) { const double br = b_re[(g * NP + p) * GH + h], bi = b_im[(g * NP + p) * GH + h];
            BBr[p * 16 + h] = (float)(cr * br - ci * bi); BBi[p * 16 + h] = (float)(cr * bi + ci * br); }
    }
    __syncthreads();
    for (int idx = tid; idx < 4096; idx += nthr) {
        const int d = idx >> 8, h = (idx >> 4) & 15, h2 = idx & 15; float acc = 0.f;
        for (int p = 0; p < NP; ++p) { const float cr = c_re[(g * GH + h) * NP + p], ci = c_im[(g * GH + h) * NP + p]; const float lr = LPr[d * 64 + p], li = LPi[d * 64 + p];
            const float clr = cr * lr - ci * li, cli = cr * li + ci * lr; acc += clr * BBr[p * 16 + h2] - cli * BBi[p * 16 + h2]; }
        KD[idx] = acc;
    }
    __syncthreads();
    bf16* TB = (bf16*)(B.ws + WS_TB) + (size_t)g * 256 * UA_LD;
    for (int idx = tid; idx < 256 * (UA_LD / 8); idx += nthr) {
        const int n = idx / (UA_LD / 8), k0 = (idx % (UA_LD / 8)) * 8, t = n >> 4, h = n & 15; float v[8];
#pragma unroll
        for (int j = 0; j < 8; ++j) { const int k = k0 + j;
            if (k < 256) { const int t2 = k >> 4, h2 = k & 15; float x = 0.f; if (t >= t2) { x = KD[(t - t2) * 256 + h * 16 + h2]; if (t == t2 && h == h2) x += dsk[g * GH + h]; } v[j] = x; }
            else { const int jj = k - 256, p = jj & 63; const float cr = c_re[(g * GH + h) * NP + p], ci = c_im[(g * GH + h) * NP + p]; const float lr = LPr[(t + 1) * 64 + p], li = LPi[(t + 1) * 64 + p];
                v[j] = jj < 64 ? (cr * lr - ci * li) : -(cr * li + ci * lr); } }
        u32x4 o; o.x = pk2(v[0], v[1]); o.y = pk2(v[2], v[3]); o.z = pk2(v[4], v[5]); o.w = pk2(v[6], v[7]);
        *(u32x4*)(TB + (size_t)n * UA_LD + k0) = o;
    }
    bf16* MT = (bf16*)(B.ws + WS_MINT) + (size_t)g * 256 * 256;
    for (int idx = tid; idx < 256 * 32; idx += nthr) {
        const int n = idx >> 5, k0 = (idx & 31) * 8; float v[8];
#pragma unroll
        for (int j = 0; j < 8; ++j) { const int k = k0 + j, t2 = k >> 4, h2 = k & 15; float x = 0.f;
            if (n < 128) { const int p = n & 63; const float lr = LPr[(CT - 1 - t2) * 64 + p], li = LPi[(CT - 1 - t2) * 64 + p]; const float br = BBr[p * 16 + h2], bi = BBi[p * 16 + h2];
                x = n < 64 ? (lr * br - li * bi) : (lr * bi + li * br); }
            v[j] = x; }
        u32x4 o; o.x = pk2(v[0], v[1]); o.y = pk2(v[2], v[3]); o.z = pk2(v[4], v[5]); o.w = pk2(v[6], v[7]);
        *(u32x4*)(MT + (size_t)n * 256 + k0) = o;
    }
    __syncthreads();
}
__device__ __forceinline__ void combine_row(const Bufs& B, int row, int lane) {
    const float lam = ((const float*)(B.ws + WS_MISC))[MISC_LAM / 4];
    const u32x4* o0 = (const u32x4*)((const bf16*)(B.ws + WS_O0) + (size_t)row * DM) + 2 * lane;
    const u32x4* o1 = (const u32x4*)((const bf16*)((unsigned char*)B.out + OUT_O1) + (size_t)row * DM) + 2 * lane;
    u32x4* ga = (u32x4*)((bf16*)(B.ws + WS_GA) + (size_t)row * DM) + 2 * lane;
    const float* sg = B.in[7] + (16 * lane & 127);
    float d[16]; float ss = 0.f;
#pragma unroll
    for (int q = 0; q < 2; ++q) { const u32x4 a = o0[q], b = o1[q];
#pragma unroll
        for (int j = 0; j < 4; ++j) { d[q * 8 + 2 * j] = bflo(a[j]) - lam * bflo(b[j]); d[q * 8 + 2 * j + 1] = bfhi(a[j]) - lam * bfhi(b[j]); } }
#pragma unroll
    for (int j = 0; j < 16; ++j) ss += d[j] * d[j];
    ss += __shfl_xor(ss, 1); ss += __shfl_xor(ss, 2); ss += __shfl_xor(ss, 4);
    const float rstd = 1.f / sqrtf(ss * (1.f / VD) + EPS) * (1.f - LAM_INIT);
#pragma unroll
    for (int q = 0; q < 2; ++q) { const u32x4 gq = ga[q]; u32x4 o;
#pragma unroll
        for (int j = 0; j < 4; ++j) { const float a0 = d[q * 8 + 2 * j] * rstd * sg[q * 8 + 2 * j] * bflo(gq[j]), a1 = d[q * 8 + 2 * j + 1] * rstd * sg[q * 8 + 2 * j + 1] * bfhi(gq[j]); o[j] = pk2(a0, a1); }
        ga[q] = o; }
}

__global__ void __launch_bounds__(256) k_prep_weights(Bufs B) {
    __shared__ float scr_[4 * 64 * 33];
    const int lane = threadIdx.x & 63, w = threadIdx.x >> 6;
    p0_weights(B, (LAS float*)scr_ + w * 64 * 33, blockIdx.x * 4 + w, gridDim.x * 4, lane);
}
__global__ void __launch_bounds__(256) k_prep_rows(Bufs B) {
    const int lane = threadIdx.x & 63, gw = blockIdx.x * 4 + (threadIdx.x >> 6), ngw = gridDim.x * 4;
    for (int m = gw; m < MTOK; m += ngw) rms_row_to_bf16(B.in[0] + (size_t)m * DM, (bf16*)(B.ws + WS_XN) + (size_t)m * DM, lane);
}
__global__ void __launch_bounds__(256) k_prep_tables(Bufs B) {
    __shared__ float lds_[17 * 64 * 2 + 2048 + 4096];
    if (blockIdx.x < NG) p0_ssm_tables(B, blockIdx.x, threadIdx.x, 256, (LAS float*)lds_);
    else p0_misc(B, threadIdx.x, 256);
}
__global__ void __launch_bounds__(256) k_combine(Bufs B) {
    const int lane = threadIdx.x & 63, gw = blockIdx.x * 4 + (threadIdx.x >> 6), ngw = gridDim.x * 4;
    for (int m = gw; m < MTOK; m += ngw) combine_row(B, m, lane);
}
__global__ void __launch_bounds__(256) k_rows_x1(Bufs B) {
    const int lane = threadIdx.x & 63, gw = blockIdx.x * 4 + (threadIdx.x >> 6), ngw = gridDim.x * 4;
    for (int m = gw; m < MTOK; m += ngw) rms_row_to_bf16(B.out + (size_t)m * DM, (bf16*)(B.ws + WS_XN) + (size_t)m * DM, lane);
}
__global__ void __launch_bounds__(256) k_rows_final(Bufs B) {
    const int lane = threadIdx.x & 63, gw = blockIdx.x * 4 + (threadIdx.x >> 6), ngw = gridDim.x * 4;
    for (int m = gw; m < MTOK; m += ngw) {
        f32x4* xr = (f32x4*)(B.out + (size_t)m * DM) + lane; const f32x4* gr = (const f32x4*)B.in[22] + lane;
        f32x4 v[4]; float s = 0.f;
#pragma unroll
        for (int j = 0; j < 4; ++j) { v[j] = xr[64 * j]; s += (v[j].x * v[j].x + v[j].y * v[j].y) + (v[j].z * v[j].z + v[j].w * v[j].w); }
        const float rstd = 1.f / sqrtf(wave_sum(s) * (1.f / DM) + EPS);
#pragma unroll
        for (int j = 0; j < 4; ++j) xr[64 * j] = v[j] * rstd * gr[64 * j];
    }
}

enum { EPI_IN = 0, EPI_GLU = 1, EPI_OUT = 2, EPI_UP = 3, EPI_DOWN = 4 };
template <int EPI> __global__ void __launch_bounds__(256) k_gemm(Bufs B, const bf16* A, int lda, const bf16* Bt, int ldb, int K) {
    const int lane = threadIdx.x & 63, w = threadIdx.x >> 6, fr = lane & 15, fq = lane >> 4;
    const int row0 = blockIdx.y * 64, pn = blockIdx.x;
    int ncol[4];
#pragma unroll
    for (int ct = 0; ct < 4; ++ct) ncol[ct] = (EPI == EPI_GLU) ? (256 * pn + 128 * (ct >> 1) + 32 * w + 16 * (ct & 1)) : (256 * pn + 64 * w + 16 * ct);
    f32x4 acc[4][4];
#pragma unroll
    for (int i = 0; i < 4; ++i)
#pragma unroll
        for (int j = 0; j < 4; ++j) acc[i][j] = (f32x4){0.f, 0.f, 0.f, 0.f};
    for (int k0 = 0; k0 < K; k0 += 32) {
        bf16x8 a[4], b[4];
#pragma unroll
        for (int i = 0; i < 4; ++i) a[i] = *(const bf16x8*)(A + (size_t)(row0 + 16 * i + fr) * lda + k0 + 8 * fq);
#pragma unroll
        for (int j = 0; j < 4; ++j) b[j] = *(const bf16x8*)(Bt + (size_t)(ncol[j] + fr) * ldb + k0 + 8 * fq);
#pragma unroll
        for (int i = 0; i < 4; ++i)
#pragma unroll
            for (int j = 0; j < 4; ++j) acc[i][j] = __builtin_amdgcn_mfma_f32_16x16x32_bf16(a[i], b[j], acc[i][j], 0, 0, 0);
    }
    unsigned char* ws = B.ws;
#pragma unroll
    for (int i = 0; i < 4; ++i)
#pragma unroll
        for (int r = 0; r < 4; ++r) {
            const int row = row0 + 16 * i + 4 * fq + r;
            if (EPI == EPI_GLU) {
#pragma unroll
                for (int j = 0; j < 2; ++j) { const int col = 128 * pn + 32 * w + 16 * j + fr; const float zv = acc[i][j][r], zg = acc[i][j + 2][r];
                    bf16* mix = (bf16*)(ws + WS_GA) + (size_t)row * DM + col; const bf16* gs = (const bf16*)((unsigned char*)B.out + OUT_GS) + (size_t)row * DM + col;
                    *mix = (bf16)f2bf(bf2f(*mix) + bf2f(*gs) * (zv * sigmoidf_(zg))); }
            } else {
#pragma unroll
                for (int j = 0; j < 4; ++j) { const int col = ncol[j] + fr; const float v = acc[i][j][r];
                    if (EPI == EPI_IN) {
                        if (col < 1024) ((bf16*)(ws + WS_Q))[(size_t)row * DM + col] = (bf16)f2bf(v * C2);
                        else if (col < 2048) ((bf16*)(ws + WS_K))[(size_t)row * DM + col - 1024] = (bf16)f2bf(v);
                        else if (col < 3072) ((bf16*)(ws + WS_V))[(size_t)row * DM + col - 2048] = (bf16)f2bf(v);
                        else if (col < 3584) { const int uc = col - 3072, g = uc >> 4, h = uc & 15, bb = row >> 11, l = row & 2047; const size_t R = (size_t)g * 1024 + bb * 128 + (l >> 4);
                            ((bf16*)(ws + WS_UA))[R * UA_LD + (l & 15) * 16 + h] = (bf16)f2bf(v); }
                        else if (col < 4608) ((bf16*)(ws + WS_GA))[(size_t)row * DM + col - 3584] = (bf16)f2bf(sigmoidf_(v));
                        else ((bf16*)((unsigned char*)B.out + OUT_GS))[(size_t)row * DM + col - 4608] = (bf16)f2bf(sigmoidf_(v));
                    } else if (EPI == EPI_OUT) { B.out[(size_t)row * DM + col] = B.in[0][(size_t)row * DM + col] + v; }
                    else if (EPI == EPI_UP) { const float t = v > 0.f ? v : 0.f; ((bf16*)(ws + WS_HB))[(size_t)row * DFF + col] = (bf16)f2bf(t * t); }
                    else if (EPI == EPI_DOWN) { B.out[(size_t)row * DM + col] += v; }
                }
            }
        }
}

__global__ void __launch_bounds__(256) k_attn_simple(Bufs B) {
    __shared__ float tb[132];
    const int b = blockIdx.z, hm = blockIdx.y, h = hm >> 1, m = hm & 1, q = blockIdx.x * 256 + threadIdx.x;
    if (threadIdx.x <= 128) tb[threadIdx.x] = B.in[8][t5_bucket_dev(threadIdx.x) * NH + h] * LOG2E;
    __syncthreads();
    const bf16* Qp = (const bf16*)(B.ws + WS_Q) + ((size_t)b * SEQ + q) * DM + h * 128 + m * 64;
    float qv[64];
#pragma unroll
    for (int d = 0; d < 64; ++d) qv[d] = bf2f(Qp[d]);
    float o[128];
#pragma unroll
    for (int j = 0; j < 128; ++j) o[j] = 0.f;
    float mx = -INFINITY, l = 0.f;
    const int kend = blockIdx.x * 256 + 255;
    for (int k = 0; k <= kend; ++k) {
        const u32x4* Kp = (const u32x4*)((const bf16*)(B.ws + WS_K) + ((size_t)b * SEQ + k) * DM + h * 128 + m * 64);
        float s = 0.f;
#pragma unroll
        for (int c = 0; c < 8; ++c) { const u32x4 kk = Kp[c];
#pragma unroll
            for (int j = 0; j < 4; ++j) { s += qv[c * 8 + 2 * j] * bflo(kk[j]); s += qv[c * 8 + 2 * j + 1] * bfhi(kk[j]); } }
        const int rel = q - k;
        s = rel >= 0 ? s + tb[rel < 128 ? rel : 128] : -INFINITY;
        const float mn = fmaxf(mx, s), a = exp2f(mx - mn), p = exp2f(s - mn);
        mx = mn; l = l * a + p;
        const u32x4* Vp = (const u32x4*)((const bf16*)(B.ws + WS_V) + ((size_t)b * SEQ + k) * DM + h * 128);
#pragma unroll
        for (int c = 0; c < 16; ++c) { const u32x4 vv = Vp[c];
#pragma unroll
            for (int j = 0; j < 4; ++j) { o[c * 8 + 2 * j] = o[c * 8 + 2 * j] * a + p * bflo(vv[j]); o[c * 8 + 2 * j + 1] = o[c * 8 + 2 * j + 1] * a + p * bfhi(vv[j]); } }
    }
    const float rl = 1.f / l;
    bf16* Op = (m == 0 ? (bf16*)(B.ws + WS_O0) : (bf16*)((unsigned char*)B.out + OUT_O1)) + ((size_t)b * SEQ + q) * DM + h * 128;
#pragma unroll
    for (int c = 0; c < 16; ++c) { u32x4 w;
#pragma unroll
        for (int j = 0; j < 4; ++j) w[j] = pk2(o[c * 8 + 2 * j] * rl, o[c * 8 + 2 * j + 1] * rl);
        ((u32x4*)Op)[c] = w; }
}

__global__ void __launch_bounds__(64) k_ssm_simple(Bufs B) {
    const int b = blockIdx.x >> 5, g = blockIdx.x & 31, p = threadIdx.x;
    const float* a_re = B.in[9]; const float* a_im = B.in[10]; const float* log_dt = B.in[11];
    const float* b_re = B.in[12]; const float* b_im = B.in[13]; const float* c_re = B.in[14]; const float* c_im = B.in[15]; const float* dsk = B.in[16];
    const double dt = exp((double)log_dt[g]); const double ar = a_re[g * NP + p], ai = a_im[g * NP + p];
    const double mag = exp(ar * dt); const double lrd = mag * cos(ai * dt), lid = mag * sin(ai * dt);
    const double nr = lrd - 1.0, ni = lid, den = ar * ar + ai * ai; const double cr = (nr * ar + ni * ai) / den, ci = (ni * ar - nr * ai) / den;
    const float lr = (float)lrd, li = (float)lid;
    float bbr[16], bbi[16], ccr[16], cci[16];
#pragma unroll
    for (int h = 0; h < 16; ++h) { const double br = b_re[(g * NP + p) * GH + h], bi = b_im[(g * NP + p) * GH + h]; bbr[h] = (float)(cr * br - ci * bi); bbi[h] = (float)(cr * bi + ci * br);
        ccr[h] = c_re[(g * GH + h) * NP + p]; cci[h] = c_im[(g * GH + h) * NP + p]; }
    const float dk = dsk[g * GH + (p & 15)];
    float sr = 0.f, si = 0.f;
    const bf16* UA = (const bf16*)(B.ws + WS_UA);
    bf16* GY = (bf16*)(B.ws + WS_GY);
    for (int l = 0; l < SEQ; ++l) {
        const size_t R = (size_t)g * 1024 + b * 128 + (l >> 4);
        const u32x4* up = (const u32x4*)(UA + R * UA_LD + (l & 15) * 16);
        const u32x4 u0 = up[0], u1 = up[1]; float u[16];
#pragma unroll
        for (int j = 0; j < 4; ++j) { u[2 * j] = bflo(u0[j]); u[2 * j + 1] = bfhi(u0[j]); u[8 + 2 * j] = bflo(u1[j]); u[8 + 2 * j + 1] = bfhi(u1[j]); }
        float br = 0.f, bi = 0.f;
#pragma unroll
        for (int h = 0; h < 16; ++h) { br += bbr[h] * u[h]; bi += bbi[h] * u[h]; }
        const float nsr = lr * sr - li * si + br, nsi = lr * si + li * sr + bi; sr = nsr; si = nsi;
        float mine = 0.f;
#pragma unroll
        for (int h = 0; h < 16; ++h) { const float part = wave_sum(ccr[h] * sr - cci[h] * si); if ((p & 15) == h) mine = part + dk * u[h]; }
        if (p < 16) GY[((size_t)b * SEQ + l) * SSMW + g * GH + p] = (bf16)f2bf(gelu_tanh(mine));
    }
}

extern "C" void kernel_launch(void* const* d_in, const int* in_sizes, int n_in, void* d_out, int out_size, void* d_ws, size_t ws_size, hipStream_t stream) {
    if (n_in != 23 || out_size != MTOK * DM || ws_size < WS_END) { fprintf(stderr, "kernel_launch: unexpected shapes (n_in %d out %d ws %zu)\n", n_in, out_size, ws_size); return; }
    Bufs B{};
    for (int i = 0; i < 23; ++i) B.in[i] = (const float*)d_in[i];
    B.out = (float*)d_out; B.ws = (unsigned char*)d_ws;
    unsigned char* ws = B.ws;
    k_prep_weights<<<1024, 256, 0, stream>>>(B);
    k_prep_rows<<<2048, 256, 0, stream>>>(B);
    k_prep_tables<<<NG + 1, 256, 0, stream>>>(B);
    k_gemm<EPI_IN><<<dim3(INW / 256, MTOK / 64), 256, 0, stream>>>(B, (const bf16*)(ws + WS_XN), DM, (const bf16*)(ws + WS_WIN), DM, DM);
    k_attn_simple<<<dim3(SEQ / 256, 16, BATCH), 256, 0, stream>>>(B);
    k_ssm_simple<<<BATCH * NG, 64, 0, stream>>>(B);
    k_combine<<<2048, 256, 0, stream>>>(B);
    k_gemm<EPI_GLU><<<dim3(2 * DM / 256, MTOK / 64), 256, 0, stream>>>(B, (const bf16*)(ws + WS_GY), SSMW, (const bf16*)(ws + WS_WGLU), SSMW, SSMW);
    k_gemm<EPI_OUT><<<dim3(DM / 256, MTOK / 64), 256, 0, stream>>>(B, (const bf16*)(ws + WS_GA), DM, (const bf16*)(ws + WS_WOUT), DM, DM);
    k_rows_x1<<<2048, 256, 0, stream>>>(B);
    k_gemm<EPI_UP><<<dim3(DFF / 256, MTOK / 64), 256, 0, stream>>>(B, (const bf16*)(ws + WS_XN), DM, (const bf16*)(ws + WS_W1), DM, DM);
    k_gemm<EPI_DOWN><<<dim3(DM / 256, MTOK / 64), 256, 0, stream>>>(B, (const bf16*)(ws + WS_HB), DFF, (const bf16*)(ws + WS_W2), DFF, DFF);
    k_rows_final<<<2048, 256, 0, stream>>>(B);
}
```
